# Optimizing an MI355X kernel written in HIP

```python
import math
import jax, jax.numpy as jnp
from jax import lax
import numpy as np

D_MODEL = 1024
BATCH = 4
SEQ = 8192
DEPTH = 1
DEC_BATCH = 2
DEC_SEQ = 8192
PAST_LEN = 128

DA_HEADS = 4
DA_DK = 64
DA_DV = 2 * DA_DK
DA_WIDTH = DA_HEADS * DA_DV
ROT_DIM = DA_DK // 4
ROPE_THETA = 500000.0
Q_BLOCK = 128
GLA_HEADS = 4
GLA_DK = 64
GLA_DV = 128
GLA_QK_WIDTH = GLA_HEADS * GLA_DK
GLA_WIDTH = GLA_HEADS * GLA_DV
GLA_RANK = 16
GLA_TAU = 16.0
GLA_CHUNK = 64
D_FF = 4 * D_MODEL
ALPHA = (2 * DEPTH) ** 0.25
BETA = (8 * DEPTH) ** -0.25
LN_EPS = 1e-5
RMS_EPS = 1e-6
IN_SIZES = (
    DA_HEADS * 2 * DA_DK,
    DA_HEADS * 2 * DA_DK,
    DA_WIDTH,
    GLA_QK_WIDTH,
    GLA_QK_WIDTH,
    GLA_WIDTH,
    GLA_WIDTH,
    GLA_RANK,
    GLA_RANK,
    2 * D_MODEL,
)
D_IN = sum(IN_SIZES)

kernel_name = "hybrid_diffattn_gla_deepnorm_encoder"


def layer_norm(x, g, b):
    xf = x.astype(jnp.float32)
    mu = jnp.mean(xf, axis=-1, keepdims=True)
    var = jnp.mean(jnp.square(xf - mu), axis=-1, keepdims=True)
    y = (xf - mu) * lax.rsqrt(var + LN_EPS) * g.astype(jnp.float32) + b.astype(jnp.float32)
    return y.astype(x.dtype)


def rms_norm(x, g):
    xf = x.astype(jnp.float32)
    y = xf * lax.rsqrt(jnp.mean(jnp.square(xf), axis=-1, keepdims=True) + RMS_EPS)
    return y * g.astype(jnp.float32)


def rope_tables(S):
    inv = 1.0 / (ROPE_THETA ** (jnp.arange(0, ROT_DIM, 2, dtype=jnp.float32) / ROT_DIM))
    ang = jnp.arange(S, dtype=jnp.float32)[:, None] * inv[None, :]
    return jnp.cos(ang), jnp.sin(ang)


def apply_partial_rope(t, cos, sin):
    rot, rest = t[..., :ROT_DIM], t[..., ROT_DIM:]
    x1, x2 = rot[..., :ROT_DIM // 2], rot[..., ROT_DIM // 2:]
    c = cos[None, :, None, None, :].astype(t.dtype)
    s = sin[None, :, None, None, :].astype(t.dtype)
    rot = jnp.concatenate([x1 * c - x2 * s, x2 * c + x1 * s], axis=-1)
    return jnp.concatenate([rot, rest], axis=-1)


def diff_attention(q, k, v, lam, lam_init, subln_g):
    B, S = q.shape[0], q.shape[1]
    nb = S // Q_BLOCK
    qb = q.reshape(B, nb, Q_BLOCK, DA_HEADS, 2, DA_DK).transpose(1, 0, 2, 3, 4, 5)
    scale = DA_DK ** -0.5

    def block(qi):
        s = jnp.einsum('bqhmd,bkhmd->bhmqk', qi, k, preferred_element_type=jnp.float32) * scale
        p = jax.nn.softmax(s, axis=-1)
        a = p[:, :, 0] - lam * p[:, :, 1]
        return jnp.einsum('bhqk,bkhv->bqhv', a.astype(v.dtype), v)

    o = lax.map(block, qb)
    o = o.transpose(1, 0, 2, 3, 4).reshape(B, S, DA_HEADS, DA_DV)
    o = rms_norm(o, subln_g) * (1.0 - lam_init)
    return o.reshape(B, S, DA_WIDTH).astype(v.dtype)


def gla_direction(q, k, v, g):
    B, H, S, DK = q.shape
    DV = v.shape[-1]
    n = S // GLA_CHUNK

    def chunks(t):
        return t.reshape(B, H, n, GLA_CHUNK, t.shape[-1]).transpose(2, 0, 1, 3, 4)

    mask = jnp.tril(jnp.ones((GLA_CHUNK, GLA_CHUNK), dtype=bool))[:, :, None]

    def step(state, inp):
        qc, kc, vc, gc = inp
        b = jnp.cumsum(gc, axis=-2)
        inter = jnp.einsum('bhtk,bhkv->bhtv', qc * jnp.exp(b), state)
        diff = b[:, :, :, None, :] - b[:, :, None, :, :]
        decay = jnp.exp(jnp.where(mask, diff, -jnp.inf))
        attn = jnp.einsum('bhtk,bhsk,bhtsk->bhts', qc, kc, decay)
        intra = jnp.einsum('bhts,bhsv->bhtv', attn, vc)
        b_last = b[:, :, -1:, :]
        state = jnp.exp(b_last[:, :, 0, :])[..., None] * state + jnp.einsum(
            'bhsk,bhsv->bhkv', kc * jnp.exp(b_last - b), vc)
        return state, inter + intra

    state0 = jnp.zeros((B, H, DK, DV), jnp.float32)
    _, o = lax.scan(step, state0, (chunks(q), chunks(k), chunks(v), chunks(g)))
    return o.transpose(1, 2, 0, 3, 4).reshape(B, H, S, DV)


def gla_branch(q, k, v, r, z_f, z_b, w_dec_f, b_dec_f, w_dec_b, b_dec_b, norm_g):
    B, S = q.shape[0], q.shape[1]

    def heads(t, d):
        return t.reshape(B, S, GLA_HEADS, d).transpose(0, 2, 1, 3).astype(jnp.float32)

    g_f = jax.nn.log_sigmoid((z_f @ w_dec_f + b_dec_f).astype(jnp.float32)) / GLA_TAU
    g_b = jax.nn.log_sigmoid((z_b @ w_dec_b + b_dec_b).astype(jnp.float32)) / GLA_TAU
    qh = heads(q, GLA_DK) * (GLA_DK ** -0.5)
    kh = heads(k, GLA_DK)
    vh = heads(v, GLA_DV)
    flip = lambda t: jnp.flip(t, axis=2)
    o_fwd = gla_direction(qh, kh, vh, heads(g_f, GLA_DK))
    o_bwd = flip(gla_direction(flip(qh), flip(kh), flip(vh), flip(heads(g_b, GLA_DK))))
    o = (o_fwd + o_bwd).transpose(0, 2, 1, 3)
    o = rms_norm(o, norm_g) * jax.nn.silu(r.reshape(B, S, GLA_HEADS, GLA_DV).astype(jnp.float32))
    return o.reshape(B, S, GLA_WIDTH).astype(v.dtype)


def encoder_layer(x, l, w_in, lam_q1, lam_k1, lam_q2, lam_k2, subln_g, w_dec_f, b_dec_f,
                  w_dec_b, b_dec_b, gla_norm_g, w_br_a, w_br_b, b_gate, w_out,
                  ln1_g, ln1_b, w_mlp1, w_mlp2, ln2_g, ln2_b):
    B, S, _ = x.shape
    split_idx = np.cumsum(IN_SIZES)[:-1].tolist()
    proj = x @ w_in
    da_q, da_k, da_v, g_q, g_k, g_v, g_r, z_f, z_b, gates = jnp.split(proj, split_idx, axis=-1)

    cos, sin = rope_tables(S)
    q = apply_partial_rope(da_q.reshape(B, S, DA_HEADS, 2, DA_DK), cos, sin)
    k = apply_partial_rope(da_k.reshape(B, S, DA_HEADS, 2, DA_DK), cos, sin)
    v = da_v.reshape(B, S, DA_HEADS, DA_DV)
    lam_init = 0.8 - 0.6 * math.exp(-0.3 * l)
    lam = (jnp.exp(jnp.sum(lam_q1.astype(jnp.float32) * lam_k1.astype(jnp.float32)))
           - jnp.exp(jnp.sum(lam_q2.astype(jnp.float32) * lam_k2.astype(jnp.float32))) + lam_init)
    y_a = diff_attention(q, k, v, lam, lam_init, subln_g)

    y_b = gla_branch(g_q, g_k, g_v, g_r, z_f, z_b, w_dec_f, b_dec_f, w_dec_b, b_dec_b, gla_norm_g)

    gate_a, gate_b = jnp.split(jax.nn.sigmoid(gates + b_gate), 2, axis=-1)
    mix = (gate_a * (y_a @ w_br_a) + gate_b * (y_b @ w_br_b)) @ w_out
    x = layer_norm(ALPHA * x + mix, ln1_g, ln1_b)

    h = jnp.square(jax.nn.relu(x @ w_mlp1)) @ w_mlp2
    return layer_norm(ALPHA * x + h, ln2_g, ln2_b)


def setup_inputs(seed: int = 0) -> dict:
    key = jax.random.key(seed)
    ks = jax.random.split(key, 24)
    f32 = jnp.float32
    nrm = lambda k, shape, s: jax.random.normal(k, shape, f32) * s
    L, D = DEPTH, D_MODEL
    return {
        "x_prompt": nrm(ks[0], (BATCH, SEQ, D), 1.0),
        "x_sample": nrm(ks[1], (DEC_BATCH, DEC_SEQ, D), 1.0),
        "w_in": nrm(ks[2], (L, D, D_IN), D ** -0.5),
        "lam_q1": nrm(ks[3], (L, DA_DK), 0.1),
        "lam_k1": nrm(ks[4], (L, DA_DK), 0.1),
        "lam_q2": nrm(ks[5], (L, DA_DK), 0.1),
        "lam_k2": nrm(ks[6], (L, DA_DK), 0.1),
        "subln_g": 1.0 + nrm(ks[7], (L, DA_DV), 0.02),
        "w_dec_f": nrm(ks[8], (L, GLA_RANK, GLA_QK_WIDTH), GLA_RANK ** -0.5),
        "b_dec_f": nrm(ks[9], (L, GLA_QK_WIDTH), 0.02),
        "w_dec_b": nrm(ks[10], (L, GLA_RANK, GLA_QK_WIDTH), GLA_RANK ** -0.5),
        "b_dec_b": nrm(ks[11], (L, GLA_QK_WIDTH), 0.02),
        "gla_norm_g": 1.0 + nrm(ks[12], (L, GLA_DV), 0.02),
        "w_br_a": nrm(ks[13], (L, DA_WIDTH, D), DA_WIDTH ** -0.5),
        "w_br_b": nrm(ks[14], (L, GLA_WIDTH, D), GLA_WIDTH ** -0.5),
        "b_gate": nrm(ks[15], (L, 2 * D), 0.02),
        "w_out": nrm(ks[16], (L, D, D), BETA * D ** -0.5),
        "ln1_g": 1.0 + nrm(ks[17], (L, D), 0.02),
        "ln1_b": nrm(ks[18], (L, D), 0.02),
        "w_mlp1": nrm(ks[19], (L, D, D_FF), D ** -0.5),
        "w_mlp2": nrm(ks[20], (L, D_FF, D), BETA * D_FF ** -0.5),
        "ln2_g": 1.0 + nrm(ks[21], (L, D), 0.02),
        "ln2_b": nrm(ks[22], (L, D), 0.02),
    }


def reference(x_prompt, x_sample, w_in, lam_q1, lam_k1, lam_q2, lam_k2, subln_g, w_dec_f, b_dec_f,
              w_dec_b, b_dec_b, gla_norm_g, w_br_a, w_br_b, b_gate, w_out,
              ln1_g, ln1_b, w_mlp1, w_mlp2, ln2_g, ln2_b):
    def trunk(x):
        for l in range(DEPTH):
            x = encoder_layer(x, l, w_in[l], lam_q1[l], lam_k1[l], lam_q2[l], lam_k2[l], subln_g[l],
                              w_dec_f[l], b_dec_f[l], w_dec_b[l], b_dec_b[l], gla_norm_g[l],
                              w_br_a[l], w_br_b[l], b_gate[l], w_out[l],
                              ln1_g[l], ln1_b[l], w_mlp1[l], w_mlp2[l], ln2_g[l], ln2_b[l])
        return x

    y_prompt = trunk(x_prompt)
    y_sample = trunk(x_sample)
    return (y_prompt, y_sample)
```

```cpp
#include <hip/hip_runtime.h>
#include <stdint.h>
#include <stdio.h>

typedef unsigned short bf16_t;
__device__ __forceinline__ float bf2f(bf16_t v) { return __uint_as_float(((unsigned)v) << 16); }
__device__ __forceinline__ bf16_t f2bf(float f) { unsigned u = __float_as_uint(f); return (bf16_t)((u + 0x7fffu + ((u >> 16) & 1u)) >> 16); }

constexpr int SEQ = 8192, NSEQ = 6, M = NSEQ * SEQ, DM = 1024, DIN = 5152, DFF = 4096;
constexpr int MP = 4 * SEQ;
constexpr float ALPHA = 1.189207115002721f;
constexpr size_t MiB = 1u << 20;
constexpr size_t WS_MISC = 1 * MiB;
constexpr size_t WS_XB = 34 * MiB;
constexpr size_t WS_DAQ = 130 * MiB;
constexpr size_t WS_GR = 178 * MiB;
constexpr size_t WS_DAK = 226 * MiB;
constexpr size_t WS_DAV = 274 * MiB;
constexpr size_t WS_GQ = 322 * MiB;
constexpr size_t WS_GK = 346 * MiB;
constexpr size_t WS_GV = 370 * MiB;
constexpr size_t WS_Z = 418 * MiB;
constexpr size_t WS_GATES = 226 * MiB;
constexpr size_t WS_X1B = 226 * MiB;
constexpr size_t WS_HDN = 322 * MiB;
constexpr size_t WS_NEED = 512 * MiB;

struct XSrc { const float* xp; const float* xs;
  __device__ __forceinline__ const float* rowp(int row) const { return row < MP ? xp + (size_t)row * DM : xs + (size_t)(row - MP) * DM; } };

struct ASrcX { XSrc x; __device__ __forceinline__ float ld(int r, int k) const { return x.rowp(r)[k]; } };
struct ASrcBf { const bf16_t* p; int lda; int roff; __device__ __forceinline__ float ld(int r, int k) const { return bf2f(p[(size_t)(r - roff) * lda + k]); } };

template <class ASrc, class Epi>
__global__ __launch_bounds__(256) void nk_gemm(ASrc A, const float* __restrict__ B, int ldb, int row0, int N, int K, Epi epi) {
  __shared__ float As[16][65]; __shared__ float Bs[16][64];
  const int tid = threadIdx.x, tx = tid & 15, ty = tid >> 4;
  const int bm = blockIdx.y * 64, bn = blockIdx.x * 64;
  float acc[4][4];
#pragma unroll
  for (int i = 0; i < 4; ++i)
#pragma unroll
    for (int j = 0; j < 4; ++j) acc[i][j] = 0.f;
  for (int k0 = 0; k0 < K; k0 += 16) {
    { const int r = tid >> 2, kk = (tid & 3) * 4;
#pragma unroll
      for (int j = 0; j < 4; ++j) As[kk + j][r] = A.ld(row0 + bm + r, k0 + kk + j); }
    { const int kk = tid >> 4, n = (tid & 15) * 4;
#pragma unroll
      for (int j = 0; j < 4; ++j) { const int col = bn + n + j; Bs[kk][n + j] = col < N ? B[(size_t)(k0 + kk) * ldb + col] : 0.f; } }
    __syncthreads();
#pragma unroll
    for (int kk = 0; kk < 16; ++kk) {
      float a[4], b[4];
#pragma unroll
      for (int i = 0; i < 4; ++i) a[i] = As[kk][ty * 4 + i];
#pragma unroll
      for (int j = 0; j < 4; ++j) b[j] = Bs[kk][tx * 4 + j];
#pragma unroll
      for (int i = 0; i < 4; ++i)
#pragma unroll
        for (int j = 0; j < 4; ++j) acc[i][j] += a[i] * b[j];
    }
    __syncthreads();
  }
#pragma unroll
  for (int i = 0; i < 4; ++i)
#pragma unroll
    for (int j = 0; j < 4; ++j) { const int row = row0 + bm + ty * 4 + i, col = bn + tx * 4 + j; if (col < N) epi(row, col, acc[i][j]); }
}

struct EpiProj { bf16_t *daq, *dak, *dav, *gq, *gk, *gv, *gr; float* z;
  __device__ __forceinline__ void operator()(int row, int col, float v) const {
    const size_t r = (size_t)row;
    if (col < 512) daq[r * 512 + col] = f2bf(v);
    else if (col < 1024) dak[r * 512 + col - 512] = f2bf(v);
    else if (col < 1536) dav[r * 512 + col - 1024] = f2bf(v);
    else if (col < 1792) gq[r * 256 + col - 1536] = f2bf(v);
    else if (col < 2048) gk[r * 256 + col - 1792] = f2bf(v);
    else if (col < 2560) gv[r * 512 + col - 2048] = f2bf(v);
    else if (col < 3072) gr[r * 512 + col - 2560] = f2bf(v);
    else z[r * 32 + col - 3072] = v;
  } };
struct EpiGates { bf16_t* gates; const float* bgate;
  __device__ __forceinline__ void operator()(int row, int col, float v) const { const float t = v + bgate[col]; gates[(size_t)row * 2048 + col] = f2bf(1.f / (1.f + expf(-t))); } };
struct EpiTA { float* ta; const bf16_t* gates;
  __device__ __forceinline__ void operator()(int row, int col, float v) const { ta[(size_t)row * DM + col] = bf2f(gates[(size_t)row * 2048 + col]) * v; } };
struct EpiT { const float* ta; const bf16_t* gates; bf16_t* t;
  __device__ __forceinline__ void operator()(int row, int col, float v) const { t[(size_t)row * DM + col] = f2bf(ta[(size_t)row * DM + col] + bf2f(gates[(size_t)row * 2048 + 1024 + col]) * v); } };
struct EpiU1 { XSrc x; float* out;
  __device__ __forceinline__ void operator()(int row, int col, float v) const { out[(size_t)row * DM + col] = ALPHA * x.rowp(row)[col] + v; } };
struct EpiHdn { bf16_t* hdn; int roff;
  __device__ __forceinline__ void operator()(int row, int col, float v) const { const float r = fmaxf(v, 0.f); hdn[(size_t)(row - roff) * DFF + col] = f2bf(r * r); } };
struct EpiU2 { float* out;
  __device__ __forceinline__ void operator()(int row, int col, float v) const { const size_t i = (size_t)row * DM + col; out[i] = ALPHA * out[i] + v; } };

__global__ __launch_bounds__(256) void nk_rope(bf16_t* daq, bf16_t* dak) {
  const size_t gid = (size_t)blockIdx.x * 256 + threadIdx.x;
  if (gid >= (size_t)M * 128) return;
  const int i = gid & 7, m = (gid >> 3) & 1, h = (gid >> 4) & 3, t = (gid >> 6) & 1; const size_t row = gid >> 7;
  bf16_t* p = (t ? dak : daq) + row * 512 + h * 128 + m * 64 + i;
  const int s = (int)(row % SEQ);
  const float inv = (float)exp(-log(500000.0) * (double)i / 8.0);
  const float ang = (float)s * inv;
  const float c = (float)cos((double)ang), sn = (float)sin((double)ang);
  const float x1 = bf2f(p[0]), x2 = bf2f(p[8]);
  p[0] = f2bf(x1 * c - x2 * sn); p[8] = f2bf(x2 * c + x1 * sn);
}
__global__ void nk_lam(const float* q1, const float* k1, const float* q2, const float* k2, float* out) {
  if (threadIdx.x == 0 && blockIdx.x == 0) { float a = 0.f, b = 0.f; for (int i = 0; i < 64; ++i) { a += q1[i] * k1[i]; b += q2[i] * k2[i]; } out[0] = expf(a) - expf(b) + 0.2f; }
}

__global__ __launch_bounds__(256) void nk_attn(bf16_t* qy, const bf16_t* __restrict__ kk, const bf16_t* __restrict__ vv, const float* lamp, const float* subln_g) {
  __shared__ float Ks[32][128]; __shared__ float Vs[32][128];
  const int qb = blockIdx.x, h = blockIdx.y, b = blockIdx.z, tid = threadIdx.x, ql = tid >> 2, c = tid & 3;
  const size_t row = (size_t)b * SEQ + qb * 64 + ql;
  float q0[16], q1[16], O0[32], O1[32];
#pragma unroll
  for (int j = 0; j < 16; ++j) { q0[j] = bf2f(qy[row * 512 + h * 128 + 16 * c + j]) * 0.125f; q1[j] = bf2f(qy[row * 512 + h * 128 + 64 + 16 * c + j]) * 0.125f; }
#pragma unroll
  for (int j = 0; j < 32; ++j) { O0[j] = 0.f; O1[j] = 0.f; }
  float m0 = -1e30f, m1 = -1e30f, l0 = 0.f, l1 = 0.f;
  for (int k0 = 0; k0 < SEQ; k0 += 32) {
    __syncthreads();
    for (int i = tid; i < 32 * 128; i += 256) { const int r = i >> 7, cc = i & 127; const size_t kr = (size_t)b * SEQ + k0 + r;
      Ks[r][cc] = bf2f(kk[kr * 512 + h * 128 + cc]); Vs[r][cc] = bf2f(vv[kr * 512 + h * 128 + cc]); }
    __syncthreads();
    for (int r = 0; r < 32; ++r) {
      float s0 = 0.f, s1 = 0.f;
#pragma unroll
      for (int j = 0; j < 16; ++j) { s0 += q0[j] * Ks[r][16 * c + j]; s1 += q1[j] * Ks[r][64 + 16 * c + j]; }
      s0 += __shfl_xor(s0, 1); s0 += __shfl_xor(s0, 2); s1 += __shfl_xor(s1, 1); s1 += __shfl_xor(s1, 2);
      const float mn0 = fmaxf(m0, s0), a0 = __expf(m0 - mn0), p0 = __expf(s0 - mn0); l0 = l0 * a0 + p0; m0 = mn0;
      const float mn1 = fmaxf(m1, s1), a1 = __expf(m1 - mn1), p1 = __expf(s1 - mn1); l1 = l1 * a1 + p1; m1 = mn1;
#pragma unroll
      for (int j = 0; j < 32; ++j) { const float v = Vs[r][32 * c + j]; O0[j] = O0[j] * a0 + p0 * v; O1[j] = O1[j] * a1 + p1 * v; }
    }
  }
  const float lam = lamp[0], il0 = 1.f / l0, il1 = 1.f / l1; float ss = 0.f;
#pragma unroll
  for (int j = 0; j < 32; ++j) { O0[j] = O0[j] * il0 - lam * O1[j] * il1; ss += O0[j] * O0[j]; }
  ss += __shfl_xor(ss, 1); ss += __shfl_xor(ss, 2);
  const float rs = rsqrtf(ss * (1.f / 128.f) + 1e-6f) * 0.8f;
#pragma unroll
  for (int j = 0; j < 32; ++j) qy[row * 512 + h * 128 + 32 * c + j] = f2bf(O0[j] * rs * subln_g[32 * c + j]);
}

__global__ __launch_bounds__(256) void nk_gla(const bf16_t* __restrict__ gq, const bf16_t* __restrict__ gk, const bf16_t* __restrict__ gv, const float* __restrict__ z,
                                               const float* __restrict__ wdec, const float* __restrict__ bdec, float* ofb, int dir, int zoff) {
  __shared__ float sq[16][64], sk[16][64], sa[16][64], sv[16][128], so[16][2][128];
  const int h = blockIdx.x, b = blockIdx.y, tid = threadIdx.x, v = tid & 127, kh = tid >> 7;
  float S[32];
#pragma unroll
  for (int j = 0; j < 32; ++j) S[j] = 0.f;
  for (int t0 = 0; t0 < SEQ; t0 += 16) {
    __syncthreads();
    for (int e = tid; e < 1024; e += 256) { const int i = e >> 6, k = e & 63; const int tok = dir == 0 ? t0 + i : SEQ - 1 - (t0 + i); const size_t row = (size_t)b * SEQ + tok;
      sq[i][k] = bf2f(gq[row * 256 + h * 64 + k]) * 0.125f; sk[i][k] = bf2f(gk[row * 256 + h * 64 + k]);
      float zz = bdec[h * 64 + k];
      for (int r = 0; r < 16; ++r) zz += z[row * 32 + zoff + r] * wdec[r * 256 + h * 64 + k];
      const float g = (fminf(zz, 0.f) - log1pf(expf(-fabsf(zz)))) * (1.f / 16.f);
      sa[i][k] = expf(g); }
    for (int e = tid; e < 2048; e += 256) { const int i = e >> 7, vv2 = e & 127; const int tok = dir == 0 ? t0 + i : SEQ - 1 - (t0 + i); const size_t row = (size_t)b * SEQ + tok;
      sv[i][vv2] = bf2f(gv[row * 512 + h * 128 + vv2]); }
    __syncthreads();
    for (int i = 0; i < 16; ++i) { const float vi = sv[i][v]; float o = 0.f;
#pragma unroll
      for (int kk2 = 0; kk2 < 32; ++kk2) { const int k = kh * 32 + kk2; S[kk2] = sa[i][k] * S[kk2] + sk[i][k] * vi; o += sq[i][k] * S[kk2]; }
      so[i][kh][v] = o; }
    __syncthreads();
    for (int e = tid; e < 2048; e += 256) { const int i = e >> 7, vv2 = e & 127; const int tok = dir == 0 ? t0 + i : SEQ - 1 - (t0 + i);
      const size_t idx = ((size_t)b * SEQ + tok) * 512 + h * 128 + vv2; const float o = so[i][0][vv2] + so[i][1][vv2];
      if (dir == 0) ofb[idx] = o; else ofb[idx] += o; }
  }
}
__global__ __launch_bounds__(256) void nk_gla_fin(const float* __restrict__ ofb, bf16_t* gr_yb, const float* __restrict__ g) {
  const size_t wv = ((size_t)blockIdx.x * 256 + threadIdx.x) >> 6; const int lane = threadIdx.x & 63;
  if (wv >= (size_t)M * 4) return;
  const size_t base = wv * 128;
  const float a = ofb[base + lane], b2 = ofb[base + 64 + lane];
  float ss = a * a + b2 * b2;
#pragma unroll
  for (int o = 1; o < 64; o <<= 1) ss += __shfl_xor(ss, o);
  const float rs = rsqrtf(ss * (1.f / 128.f) + 1e-6f);
  const float r0 = bf2f(gr_yb[base + lane]), r1 = bf2f(gr_yb[base + 64 + lane]);
  gr_yb[base + lane] = f2bf(a * rs * g[lane] * (r0 / (1.f + expf(-r0))));
  gr_yb[base + 64 + lane] = f2bf(b2 * rs * g[64 + lane] * (r1 / (1.f + expf(-r1))));
}
__global__ __launch_bounds__(256) void nk_ln(float* x, const float* __restrict__ g, const float* __restrict__ bta, bf16_t* xb) {
  const size_t row = ((size_t)blockIdx.x * 256 + threadIdx.x) >> 6; const int lane = threadIdx.x & 63;
  if (row >= (size_t)M) return;
  float* p = x + row * DM; float v[16]; float s = 0.f;
#pragma unroll
  for (int j = 0; j < 16; ++j) { v[j] = p[lane + 64 * j]; s += v[j]; }
#pragma unroll
  for (int o = 1; o < 64; o <<= 1) s += __shfl_xor(s, o);
  const float mu = s * (1.f / DM); float q = 0.f;
#pragma unroll
  for (int j = 0; j < 16; ++j) { v[j] -= mu; q += v[j] * v[j]; }
#pragma unroll
  for (int o = 1; o < 64; o <<= 1) q += __shfl_xor(q, o);
  const float rs = rsqrtf(q * (1.f / DM) + 1e-5f);
#pragma unroll
  for (int j = 0; j < 16; ++j) { const int c = lane + 64 * j; const float y = v[j] * rs * g[c] + bta[c]; p[c] = y; if (xb) xb[row * DM + c] = f2bf(y); }
}

extern "C" void kernel_launch(void* const* d_in, const int* in_sizes, int n_in, void* d_out, int out_size, void* d_ws, size_t ws_size, hipStream_t stream) {
  if (n_in != 23 || ws_size < WS_NEED || out_size != M * DM) { fprintf(stderr, "kernel_launch: unexpected shapes n_in %d ws %zu out %d\n", n_in, ws_size, out_size); return; }
  const float* xp = (const float*)d_in[0]; const float* xs = (const float*)d_in[1]; const float* w_in = (const float*)d_in[2];
  const float* subln_g = (const float*)d_in[7];
  const float* w_dec_f = (const float*)d_in[8]; const float* b_dec_f = (const float*)d_in[9]; const float* w_dec_b = (const float*)d_in[10]; const float* b_dec_b = (const float*)d_in[11];
  const float* gla_norm_g = (const float*)d_in[12]; const float* w_br_a = (const float*)d_in[13]; const float* w_br_b = (const float*)d_in[14]; const float* b_gate = (const float*)d_in[15];
  const float* w_out = (const float*)d_in[16]; const float* ln1_g = (const float*)d_in[17]; const float* ln1_b = (const float*)d_in[18];
  const float* w_mlp1 = (const float*)d_in[19]; const float* w_mlp2 = (const float*)d_in[20]; const float* ln2_g = (const float*)d_in[21]; const float* ln2_b = (const float*)d_in[22];
  char* ws = (char*)d_ws; float* out = (float*)d_out;
  float* lam = (float*)(ws + WS_MISC);
  bf16_t* daq = (bf16_t*)(ws + WS_DAQ); bf16_t* dak = (bf16_t*)(ws + WS_DAK); bf16_t* dav = (bf16_t*)(ws + WS_DAV);
  bf16_t* gq = (bf16_t*)(ws + WS_GQ); bf16_t* gk = (bf16_t*)(ws + WS_GK); bf16_t* gv = (bf16_t*)(ws + WS_GV); bf16_t* gr = (bf16_t*)(ws + WS_GR);
  float* z = (float*)(ws + WS_Z); bf16_t* gates = (bf16_t*)(ws + WS_GATES); bf16_t* T = (bf16_t*)(ws + WS_XB); bf16_t* x1b = (bf16_t*)(ws + WS_X1B); bf16_t* hdn = (bf16_t*)(ws + WS_HDN);
  XSrc X{xp, xs};
  nk_gemm<ASrcX, EpiProj><<<dim3((3104 + 63) / 64, M / 64), 256, 0, stream>>>(ASrcX{X}, w_in, DIN, 0, 3104, DM, EpiProj{daq, dak, dav, gq, gk, gv, gr, z});
  nk_rope<<<(unsigned)(((size_t)M * 128 + 255) / 256), 256, 0, stream>>>(daq, dak);
  nk_lam<<<1, 64, 0, stream>>>((const float*)d_in[3], (const float*)d_in[4], (const float*)d_in[5], (const float*)d_in[6], lam);
  nk_attn<<<dim3(SEQ / 64, 4, NSEQ), 256, 0, stream>>>(daq, dak, dav, lam, subln_g);
  nk_gla<<<dim3(4, NSEQ), 256, 0, stream>>>(gq, gk, gv, z, w_dec_f, b_dec_f, out, 0, 0);
  nk_gla<<<dim3(4, NSEQ), 256, 0, stream>>>(gq, gk, gv, z, w_dec_b, b_dec_b, out, 1, 16);
  nk_gla_fin<<<(unsigned)(((size_t)M * 4 * 64 + 255) / 256), 256, 0, stream>>>(out, gr, gla_norm_g);
  nk_gemm<ASrcX, EpiGates><<<dim3(2048 / 64, M / 64), 256, 0, stream>>>(ASrcX{X}, w_in + 3104, DIN, 0, 2048, DM, EpiGates{gates, b_gate});
  nk_gemm<ASrcBf, EpiTA><<<dim3(DM / 64, M / 64), 256, 0, stream>>>(ASrcBf{daq, 512, 0}, w_br_a, DM, 0, DM, 512, EpiTA{out, gates});
  nk_gemm<ASrcBf, EpiT><<<dim3(DM / 64, M / 64), 256, 0, stream>>>(ASrcBf{gr, 512, 0}, w_br_b, DM, 0, DM, 512, EpiT{out, gates, T});
  nk_gemm<ASrcBf, EpiU1><<<dim3(DM / 64, M / 64), 256, 0, stream>>>(ASrcBf{T, DM, 0}, w_out, DM, 0, DM, DM, EpiU1{X, out});
  nk_ln<<<(unsigned)(((size_t)M * 64 + 255) / 256), 256, 0, stream>>>(out, ln1_g, ln1_b, x1b);
  for (int r = 0; r < 3; ++r) {
    const int row0 = r * 16384;
    nk_gemm<ASrcBf, EpiHdn><<<dim3(DFF / 64, 16384 / 64), 256, 0, stream>>>(ASrcBf{x1b, DM, 0}, w_mlp1, DFF, row0, DFF, DM, EpiHdn{hdn, row0});
    nk_gemm<ASrcBf, EpiU2><<<dim3(DM / 64, 16384 / 64), 256, 0, stream>>>(ASrcBf{hdn, DFF, row0}, w_mlp2, DM, row0, DM, DFF, EpiU2{out});
  }
  nk_ln<<<(unsigned)(((size_t)M * 64 + 255) / 256), 256, 0, stream>>>(out, ln2_g, ln2_b, nullptr);
}
```
